# Optimizing an MI355X kernel written in HIP

```python
import math
import jax, jax.numpy as jnp
from jax import lax
import numpy as np

D_MODEL = 1024
BATCH = 2
SEQ = 8192
DEPTH = 1
DEC_BATCH = 16
DEC_SEQ = 16
PAST_LEN = 2048

CHUNK = 64
D_SSM = 512
SSM_GROUP = 16
N_SSM_GROUPS = D_SSM // SSM_GROUP
SSM_STATE = 64
D_POOL = 256
POOL_WINDOWS = (2, 4, 8, 16)
N_POOL_GROUPS = len(POOL_WINDOWS)
POOL_GROUP = D_POOL // N_POOL_GROUPS
POOL_BUF = max(POOL_WINDOWS) - 1
N_MEM = 256
MEM_HEADS = 4
D_MEM = 256
MEM_HEAD_DIM = D_MEM // MEM_HEADS
D_MIX = D_SSM + D_POOL + D_MEM
N_BRANCH = 3
D_FF = 2816
CONV_W = 3
EPS = 1e-6
DT_MIN = 1e-3
DT_MAX = 1e-1

kernel_name = "hybrid_streaming_encoder_step"

F32 = jnp.float32


def rmsnorm(x, g):
    xf = x.astype(F32)
    y = xf * lax.rsqrt(jnp.mean(xf * xf, axis=-1, keepdims=True) + EPS)
    return (y * g.astype(F32)).astype(x.dtype)


def s5_scan(u, h0_re, h0_im, lam_re, lam_im, log_dt, b_re, b_im, c_re, c_im, d_skip):
    bsz, L, _ = u.shape
    uf = u.astype(F32)
    ug = uf.reshape(bsz, L, N_SSM_GROUPS, SSM_GROUP)
    lr = lam_re.astype(F32)
    li = lam_im.astype(F32)
    dt = jnp.exp(log_dt.astype(F32))[:, None]
    mag = jnp.exp(lr * dt)
    ab_re = mag * jnp.cos(li * dt)
    ab_im = mag * jnp.sin(li * dt)
    den = lr * lr + li * li
    nr = ab_re - 1.0
    ni = ab_im
    z_re = (nr * lr + ni * li) / den
    z_im = (ni * lr - nr * li) / den
    br = b_re.astype(F32)
    bi = b_im.astype(F32)
    bb_re = z_re[..., None] * br - z_im[..., None] * bi
    bb_im = z_re[..., None] * bi + z_im[..., None] * br
    bu_re = jnp.einsum('gnh,blgh->blgn', bb_re, ug)
    bu_im = jnp.einsum('gnh,blgh->blgn', bb_im, ug)
    h0r = h0_re.astype(F32)
    h0i = h0_im.astype(F32)
    bu_re = bu_re.at[:, 0].add(ab_re * h0r - ab_im * h0i)
    bu_im = bu_im.at[:, 0].add(ab_re * h0i + ab_im * h0r)
    a_re = jnp.broadcast_to(ab_re, bu_re.shape)
    a_im = jnp.broadcast_to(ab_im, bu_im.shape)

    def combine(e1, e2):
        a1r, a1i, b1r, b1i = e1
        a2r, a2i, b2r, b2i = e2
        return (a2r * a1r - a2i * a1i,
                a2r * a1i + a2i * a1r,
                a2r * b1r - a2i * b1i + b2r,
                a2r * b1i + a2i * b1r + b2i)

    _, _, hr, hi = lax.associative_scan(combine, (a_re, a_im, bu_re, bu_im), axis=1)
    y = (jnp.einsum('ghn,blgn->blgh', c_re.astype(F32), hr)
         - jnp.einsum('ghn,blgn->blgh', c_im.astype(F32), hi))
    y = y.reshape(bsz, L, D_SSM) + d_skip.astype(F32) * uf
    return y.astype(u.dtype), hr[:, -1].astype(h0_re.dtype), hi[:, -1].astype(h0_im.dtype)


def multiscale_pool(u, buf, pos0, w_pool, pool_scale):
    bsz, L, _ = u.shape
    ext = jnp.concatenate([buf.astype(u.dtype), u], axis=1)
    cs = jnp.cumsum(ext.astype(F32), axis=1)
    cs = jnp.concatenate([jnp.zeros_like(cs[:, :1]), cs], axis=1)
    end = cs[:, POOL_BUF + 1:POOL_BUF + 1 + L]
    pos = pos0 + jnp.arange(L)
    means = []
    for gi, w in enumerate(POOL_WINDOWS):
        sl = slice(gi * POOL_GROUP, (gi + 1) * POOL_GROUP)
        start = cs[:, POOL_BUF + 1 - w:POOL_BUF + 1 - w + L, sl]
        cnt = jnp.minimum(pos + 1, w).astype(F32)[None, :, None]
        means.append((end[..., sl] - start) / cnt)
    diff = jnp.concatenate(means, axis=-1) - u.astype(F32)
    diff = diff.astype(u.dtype).reshape(bsz, L, N_POOL_GROUPS, POOL_GROUP)
    y = jnp.einsum('blgc,gcd->blgd', diff, w_pool).reshape(bsz, L, D_POOL) * pool_scale
    return y, ext[:, -POOL_BUF:]


def memory_kv(mem, g_mem, w_mem_k, w_mem_v):
    bsz = mem.shape[0]
    mn = rmsnorm(mem, g_mem)
    k = (mn @ w_mem_k).reshape(bsz, N_MEM, MEM_HEADS, MEM_HEAD_DIM)
    v = (mn @ w_mem_v).reshape(bsz, N_MEM, MEM_HEADS, MEM_HEAD_DIM)
    return k, v


def memory_attention(q, mk, mv):
    bsz, L, _ = q.shape
    qh = q.reshape(bsz, L, MEM_HEADS, MEM_HEAD_DIM)
    s = jnp.einsum('blhd,bmhd->bhlm', qh.astype(F32), mk.astype(F32)) * (MEM_HEAD_DIM ** -0.5)
    p = jax.nn.softmax(s, axis=-1).astype(mv.dtype)
    o = jnp.einsum('bhlm,bmhd->blhd', p, mv)
    return o.reshape(bsz, L, D_MEM).astype(q.dtype)


def conv_ffn(h, buf, w_ffn_up, w_dw, b_dw, w_ffn_down):
    L = h.shape[1]
    up = h @ w_ffn_up
    a, g = jnp.split(up, 2, axis=-1)
    ext = jnp.concatenate([buf.astype(a.dtype), a], axis=1)
    conv = ext[:, 0:L] * w_dw[0]
    for k in range(1, CONV_W):
        conv = conv + ext[:, k:k + L] * w_dw[k]
    conv = conv + b_dw
    act = jax.nn.gelu(conv) * g
    return act @ w_ffn_down, ext[:, -(CONV_W - 1):]


def layer(x, mk, mv, ssm_re, ssm_im, pool_buf, conv_buf, pos0, p):
    bsz, L, _ = x.shape
    h = rmsnorm(x, p['g_pre1'])
    z = h @ p['w_in']
    u_ssm = z[..., :D_SSM]
    u_pool = z[..., D_SSM:D_SSM + D_POOL]
    q_mem = z[..., D_SSM + D_POOL:]
    y_ssm, ssm_re_new, ssm_im_new = s5_scan(u_ssm, ssm_re, ssm_im, p['ssm_lam_re'], p['ssm_lam_im'],
                                            p['ssm_log_dt'], p['ssm_b_re'], p['ssm_b_im'],
                                            p['ssm_c_re'], p['ssm_c_im'], p['ssm_d'])
    y_ssm = jax.nn.gelu(y_ssm)
    y_ssm = y_ssm * jax.nn.sigmoid(y_ssm @ p['w_glu'] + p['b_glu'])
    y_pool, pool_new = multiscale_pool(u_pool, pool_buf, pos0, p['w_pool'], p['pool_scale'])
    y_mem = memory_attention(q_mem, mk, mv)
    gates = jax.nn.sigmoid(h @ p['w_gate'] + p['b_gate']).reshape(bsz, L, N_BRANCH, D_MODEL)
    merged = (gates[:, :, 0] * (y_ssm @ p['w_br_ssm'])
              + gates[:, :, 1] * (y_pool @ p['w_br_pool'])
              + gates[:, :, 2] * (y_mem @ p['w_br_mem']))
    x = x + rmsnorm(merged @ p['w_out'], p['g_post1'])
    h2 = rmsnorm(x, p['g_pre2'])
    f, conv_new = conv_ffn(h2, conv_buf, p['w_ffn_up'], p['w_dw'], p['b_dw'], p['w_ffn_down'])
    x = x + rmsnorm(f, p['g_post2'])
    return x, ssm_re_new, ssm_im_new, pool_new, conv_new


def setup_inputs(seed: int = 0) -> dict:
    key = jax.random.key(seed)
    ks = iter(jax.random.split(key, 48))

    def nrm(shape, scale=1.0):
        return jax.random.normal(next(ks), shape, F32) * scale

    def gain(shape):
        return 1.0 + nrm(shape, 0.02)

    G, N, H = N_SSM_GROUPS, SSM_STATE, SSM_GROUP
    lam_im0 = jnp.pi * jnp.arange(N, dtype=F32)
    inp = {
        'x_prompt': nrm((BATCH, SEQ, D_MODEL)),
        'x_sample': nrm((DEC_BATCH, DEC_SEQ, D_MODEL)),
        'mem_prompt': nrm((BATCH, N_MEM, D_MODEL)),
        'cache_mem_k': nrm((DEPTH, DEC_BATCH, N_MEM, MEM_HEADS, MEM_HEAD_DIM)),
        'cache_mem_v': nrm((DEPTH, DEC_BATCH, N_MEM, MEM_HEADS, MEM_HEAD_DIM)),
        'state_ssm_re': nrm((DEPTH, DEC_BATCH, G, N), 0.5),
        'state_ssm_im': nrm((DEPTH, DEC_BATCH, G, N), 0.5),
        'state_pool': nrm((DEPTH, DEC_BATCH, POOL_BUF, D_POOL)),
        'state_conv': nrm((DEPTH, DEC_BATCH, CONV_W - 1, D_FF)),
        'g_pre1': gain((DEPTH, D_MODEL)),
        'w_in': nrm((DEPTH, D_MODEL, D_MIX), D_MODEL ** -0.5),
        'ssm_lam_re': -0.5 + nrm((DEPTH, G, N), 0.01),
        'ssm_lam_im': lam_im0 + nrm((DEPTH, G, N), 0.01),
        'ssm_log_dt': jax.random.uniform(next(ks), (DEPTH, G), F32, math.log(DT_MIN), math.log(DT_MAX)),
        'ssm_b_re': nrm((DEPTH, G, N, H), (2.0 * H) ** -0.5),
        'ssm_b_im': nrm((DEPTH, G, N, H), (2.0 * H) ** -0.5),
        'ssm_c_re': nrm((DEPTH, G, H, N), (2.0 * N) ** -0.5),
        'ssm_c_im': nrm((DEPTH, G, H, N), (2.0 * N) ** -0.5),
        'ssm_d': nrm((DEPTH, D_SSM)),
        'w_glu': nrm((DEPTH, D_SSM, D_SSM), D_SSM ** -0.5),
        'b_glu': nrm((DEPTH, D_SSM), 0.02),
        'w_pool': nrm((DEPTH, N_POOL_GROUPS, POOL_GROUP, POOL_GROUP), POOL_GROUP ** -0.5),
        'pool_scale': gain((DEPTH, D_POOL)),
        'g_mem': gain((DEPTH, D_MODEL)),
        'w_mem_k': nrm((DEPTH, D_MODEL, D_MEM), D_MODEL ** -0.5),
        'w_mem_v': nrm((DEPTH, D_MODEL, D_MEM), D_MODEL ** -0.5),
        'w_gate': nrm((DEPTH, D_MODEL, N_BRANCH * D_MODEL), D_MODEL ** -0.5),
        'b_gate': nrm((DEPTH, N_BRANCH * D_MODEL), 0.02),
        'w_br_ssm': nrm((DEPTH, D_SSM, D_MODEL), D_SSM ** -0.5),
        'w_br_pool': nrm((DEPTH, D_POOL, D_MODEL), D_POOL ** -0.5),
        'w_br_mem': nrm((DEPTH, D_MEM, D_MODEL), D_MEM ** -0.5),
        'w_out': nrm((DEPTH, D_MODEL, D_MODEL), D_MODEL ** -0.5),
        'g_post1': gain((DEPTH, D_MODEL)),
        'g_pre2': gain((DEPTH, D_MODEL)),
        'w_ffn_up': nrm((DEPTH, D_MODEL, 2 * D_FF), D_MODEL ** -0.5),
        'w_dw': nrm((DEPTH, CONV_W, D_FF), CONV_W ** -0.5),
        'b_dw': nrm((DEPTH, D_FF), 0.02),
        'w_ffn_down': nrm((DEPTH, D_FF, D_MODEL), D_FF ** -0.5),
        'g_post2': gain((DEPTH, D_MODEL)),
    }
    return inp


def reference(x_prompt, x_sample, mem_prompt, cache_mem_k, cache_mem_v, state_ssm_re, state_ssm_im,
              state_pool, state_conv, g_pre1, w_in, ssm_lam_re, ssm_lam_im, ssm_log_dt, ssm_b_re,
              ssm_b_im, ssm_c_re, ssm_c_im, ssm_d, w_glu, b_glu, w_pool, pool_scale, g_mem, w_mem_k,
              w_mem_v, w_gate, b_gate, w_br_ssm, w_br_pool, w_br_mem, w_out, g_post1, g_pre2,
              w_ffn_up, w_dw, b_dw, w_ffn_down, g_post2):
    xp = x_prompt
    xs = x_sample
    mk_l, mv_l = [], []
    srp_l, sip_l, srs_l, sis_l = [], [], [], []
    pp_l, ps_l, cp_l, cs_l = [], [], [], []
    dt = x_prompt.dtype
    for l in range(DEPTH):
        p = dict(g_pre1=g_pre1[l], w_in=w_in[l], ssm_lam_re=ssm_lam_re[l], ssm_lam_im=ssm_lam_im[l],
                 ssm_log_dt=ssm_log_dt[l], ssm_b_re=ssm_b_re[l], ssm_b_im=ssm_b_im[l],
                 ssm_c_re=ssm_c_re[l], ssm_c_im=ssm_c_im[l], ssm_d=ssm_d[l], w_glu=w_glu[l],
                 b_glu=b_glu[l], w_pool=w_pool[l], pool_scale=pool_scale[l], w_gate=w_gate[l],
                 b_gate=b_gate[l], w_br_ssm=w_br_ssm[l], w_br_pool=w_br_pool[l], w_br_mem=w_br_mem[l],
                 w_out=w_out[l], g_post1=g_post1[l], g_pre2=g_pre2[l], w_ffn_up=w_ffn_up[l],
                 w_dw=w_dw[l], b_dw=b_dw[l], w_ffn_down=w_ffn_down[l], g_post2=g_post2[l])
        mk_p, mv_p = memory_kv(mem_prompt, g_mem[l], w_mem_k[l], w_mem_v[l])
        z_ssm = jnp.zeros((BATCH, N_SSM_GROUPS, SSM_STATE), dt)
        z_pool = jnp.zeros((BATCH, POOL_BUF, D_POOL), dt)
        z_conv = jnp.zeros((BATCH, CONV_W - 1, D_FF), dt)
        xp, sr_p, si_p, pb_p, cb_p = layer(xp, mk_p, mv_p, z_ssm, z_ssm, z_pool, z_conv, 0, p)
        xs, sr_s, si_s, pb_s, cb_s = layer(xs, cache_mem_k[l], cache_mem_v[l], state_ssm_re[l],
                                           state_ssm_im[l], state_pool[l], state_conv[l], PAST_LEN, p)
        mk_l.append(mk_p)
        mv_l.append(mv_p)
        srp_l.append(sr_p)
        sip_l.append(si_p)
        srs_l.append(sr_s)
        sis_l.append(si_s)
        pp_l.append(pb_p)
        ps_l.append(pb_s)
        cp_l.append(cb_p)
        cs_l.append(cb_s)
    return (xp, xs, jnp.stack(mk_l), jnp.stack(mv_l), jnp.stack(srp_l), jnp.stack(sip_l),
            jnp.stack(srs_l), jnp.stack(sis_l), jnp.stack(pp_l), jnp.stack(ps_l),
            jnp.stack(cp_l), jnp.stack(cs_l))
```

```cpp
#include <hip/hip_runtime.h>
#include <cstdio>
#include <cstdint>

constexpr int D = 1024, MP = 16384, MS = 256, NTOK = MP + MS, SEQ = 8192;
constexpr int NCH = NTOK / 16, NCHP = 1280;
constexpr int DFF = 2816, NUP = 2 * DFF;
constexpr int H2ROWS = NTOK + 256;
constexpr float EPS = 1e-6f;

namespace pg8 {
#define PG8_LAS __attribute__((address_space(3)))
typedef unsigned short bf16_t;
typedef short bf16x8 __attribute__((ext_vector_type(8)));
typedef float f32x4 __attribute__((ext_vector_type(4)));
typedef unsigned u32x4 __attribute__((ext_vector_type(4)));
typedef unsigned u32x2 __attribute__((ext_vector_type(2)));
constexpr int BM = 256, BK = 64, HALF = 128, HTB = HALF * BK * 2, STAGE_BYTES = 8 * HTB, NXCD = 8, WGM = 8;

__host__ __device__ __forceinline__ int lds_byte(int r, int c) { const int st = (r >> 4) * 2 + (c >> 5), rr = r & 15, cc = c & 31, ob = rr * 64 + cc * 2; return st * 1024 + (ob ^ (((ob >> 9) & 1) << 5)); }
__host__ __device__ __forceinline__ void stage_rc(int b, int& R, int& C) { const int st = b / 1024, sb = b % 1024, swz = sb ^ (((sb >> 9) & 1) << 5); R = (st >> 1) * 16 + swz / 64; C = (st & 1) * 32 + (swz % 64) / 2; }
__host__ __device__ __forceinline__ int perm32(int rho) { const int n = rho >> 4, i = rho & 15; return 8 * (i >> 2) + 4 * n + (i & 3); }

struct Unit { int pm, pn, pb; };
struct Gemm { const bf16_t* A; const bf16_t* Bt; int lda, ldb, K; size_t bsA, bsB; };
struct Ctx { int wr, wc, fr, fq, wid, lane; PG8_LAS unsigned char* xl; };

struct StaticOrder {
    int nM, nN, nwg, G, c;
    __device__ void init(int nM_, int nN_, int G_, int c_) { nM = nM_; nN = nN_; nwg = nM * nN; G = G_; c = c_; }
    __device__ bool map(long L, Unit& u) const {
        if (L >= nwg) return false;
        int wgid = (int)L; { const int q = nwg / NXCD, r = nwg % NXCD, xcd = wgid % NXCD, off = wgid / NXCD; wgid = (xcd < r ? xcd * (q + 1) : r * (q + 1) + (xcd - r) * q) + off; }
        const int nig = WGM * nN, gid = wgid / nig, fm = gid * WGM, gsz = (nM - fm) < WGM ? (nM - fm) : WGM;
        u.pm = fm + ((wgid % nig) % gsz); u.pn = (wgid % nig) / gsz; u.pb = 0; return true;
    }
    __device__ bool next(int i, Unit& u) const { return map((long)i * G + c, u); }
};
struct BatchOrder {
    int nM, nN, nB, G, c;
    __device__ bool next(int i, Unit& u) const { const long L = (long)i * G + c; if (L >= (long)nM * nN * nB) return false; const int per = nM * nN, l = (int)L; u.pb = l / per; const int r = l % per; u.pm = r / nN; u.pn = r % nN; return true; }
};
struct SubsetOrder {
    int c0, n, nN, c;
    __device__ bool next(int i, Unit& u) const { if (i != 0 || c < c0 || c >= c0 + n) return false; const int k = c - c0; u.pm = k / nN; u.pn = k % nN; u.pb = 0; return true; }
};
struct HaloOrder { int c; __device__ bool next(int i, Unit& u) const { if (i != 0 || c >= 22) return false; u.pm = 65; u.pn = c; u.pb = 0; return true; } };
struct UpOrder {
    StaticOrder s; int G, c;
    __device__ bool next(int i, Unit& u) const { const long L = (long)i * G + c; if (L < s.nwg) return s.map(L, u); if (L < s.nwg + 22) { u.pm = 64; u.pn = (int)(L - s.nwg); u.pb = 0; return true; } return false; }
};

__device__ __forceinline__ unsigned cvt_pk_bf16(float lo, float hi) { unsigned r; asm volatile("v_cvt_pk_bf16_f32 %0, %1, %2" : "=v"(r) : "v"(lo), "v"(hi)); return r; }
__device__ __forceinline__ float bf_lo(unsigned w) { return __uint_as_float(w << 16); }
__device__ __forceinline__ float bf_hi(unsigned w) { return __uint_as_float(w & 0xffff0000u); }
__device__ __forceinline__ float sigmoidf_(float x) { return __builtin_amdgcn_rcpf(1.0f + __builtin_amdgcn_exp2f(-1.4426950408889634f * x)); }
__device__ __forceinline__ float gelu_tanh(float x) { const float u = x * (0.7978845608028654f + 0.035677408136300125f * x * x); return x * __builtin_amdgcn_rcpf(1.0f + __builtin_amdgcn_exp2f(-2.8853900817779268f * u)); }
__device__ __forceinline__ u32x4 pack8(const f32x4& a, const f32x4& b) { u32x4 w; w.x = cvt_pk_bf16(a[0], a[1]); w.y = cvt_pk_bf16(a[2], a[3]); w.z = cvt_pk_bf16(b[0], b[1]); w.w = cvt_pk_bf16(b[2], b[3]); return w; }
__device__ __forceinline__ void unpack8(const u32x4& w, f32x4& a, f32x4& b) { a = (f32x4){bf_lo(w.x), bf_hi(w.x), bf_lo(w.y), bf_hi(w.y)}; b = (f32x4){bf_lo(w.z), bf_hi(w.z), bf_lo(w.w), bf_hi(w.w)}; }

#define ROWOF(u, c, ai, m) ((u).pm * BM + (ai) * HALF + (c).wr * 64 + (m) * 16 + (c).fr)
#define COL8(u, c, bj) ((u).pn * BM + (bj) * HALF + (c).wc * 32 + 8 * (c).fq)
#define COL4(u, c, bj, n) ((u).pn * BM + (bj) * HALF + (c).wc * 32 + 16 * (n) + 4 * (c).fq)

struct EpiP1 {
    static constexpr bool PERM = true, AFTER_DRAIN = false, HOOK = false;
    bf16_t* AS; bf16_t* ZP; bf16_t* ZQ; bf16_t* GT; const float* b_gate;
    __device__ __forceinline__ void hook(f32x4 (&)[2][2][4][2], const Unit&, int, const Ctx&) const {}
    __device__ __forceinline__ void operator()(f32x4 (&acc)[2][2][4][2], const Unit& u, const Ctx& c) const {
#pragma unroll
        for (int bj = 0; bj < 2; ++bj) {
            const int c0 = COL8(u, c, bj);
            f32x4 b0 = (f32x4){0.f, 0.f, 0.f, 0.f}, b1 = b0;
            if (u.pn >= 4) { b0 = *(const f32x4*)(b_gate + c0 - 1024); b1 = *(const f32x4*)(b_gate + c0 - 1024 + 4); }
#pragma unroll
            for (int ai = 0; ai < 2; ++ai)
#pragma unroll
                for (int m = 0; m < 4; ++m) {
                    const int r = ROWOF(u, c, ai, m);
                    f32x4 v0 = acc[ai][bj][m][0], v1 = acc[ai][bj][m][1];
                    bf16_t* dst;
                    if (u.pn < 2) { const int sg = c0 >> 5, j = c0 & 31; dst = AS + ((size_t)(sg * NCHP + (r >> 4)) * 768 + (r & 15) * 32 + j); }
                    else if (u.pn == 2) dst = ZP + (size_t)r * 256 + (c0 - 512);
                    else if (u.pn == 3) dst = ZQ + (size_t)r * 256 + (c0 - 768);
                    else { v0 += b0; v1 += b1;
#pragma unroll
                        for (int i = 0; i < 4; ++i) { v0[i] = sigmoidf_(v0[i]); v1[i] = sigmoidf_(v1[i]); }
                        dst = GT + (size_t)r * 3072 + (c0 - 1024); }
                    *(u32x4*)dst = pack8(v0, v1);
                }
        }
    }
};
struct EpiF32 {
    static constexpr bool PERM = false, AFTER_DRAIN = false, HOOK = false;
    float* O; int ldc; size_t bs;
    __device__ __forceinline__ void hook(f32x4 (&)[2][2][4][2], const Unit&, int, const Ctx&) const {}
    __device__ __forceinline__ void operator()(f32x4 (&acc)[2][2][4][2], const Unit& u, const Ctx& c) const {
        float* base = O + (size_t)u.pb * bs;
#pragma unroll
        for (int ai = 0; ai < 2; ++ai)
#pragma unroll
            for (int m = 0; m < 4; ++m) { const int r = ROWOF(u, c, ai, m);
#pragma unroll
                for (int bj = 0; bj < 2; ++bj)
#pragma unroll
                    for (int n = 0; n < 2; ++n) *(f32x4*)(base + (size_t)r * ldc + COL4(u, c, bj, n)) = acc[ai][bj][m][n]; }
    }
};
struct EpiY {
    static constexpr bool PERM = true, AFTER_DRAIN = false, HOOK = false;
    const bf16_t* AS; const float* dskip; bf16_t* YG;
    __device__ __forceinline__ void hook(f32x4 (&)[2][2][4][2], const Unit&, int, const Ctx&) const {}
    __device__ __forceinline__ void operator()(f32x4 (&acc)[2][2][4][2], const Unit& u, const Ctx& c) const {
        const int j0 = 8 * c.fq;
        const f32x4 d0 = *(const f32x4*)(dskip + u.pb * 32 + j0), d1 = *(const f32x4*)(dskip + u.pb * 32 + j0 + 4);
#pragma unroll
        for (int ai = 0; ai < 2; ++ai)
#pragma unroll
            for (int m = 0; m < 4; ++m) { const int ch = ROWOF(u, c, ai, m);
                if (ch < NCH) {
#pragma unroll
                    for (int bj = 0; bj < 2; ++bj) { const int tau = u.pn * 8 + bj * 4 + c.wc;
                        const u32x4 uw = *(const u32x4*)(AS + ((size_t)(u.pb * NCHP + ch) * 768 + tau * 32 + j0));
                        f32x4 u0, u1; unpack8(uw, u0, u1);
                        f32x4 v0 = acc[ai][bj][m][0] + d0 * u0, v1 = acc[ai][bj][m][1] + d1 * u1;
#pragma unroll
                        for (int i = 0; i < 4; ++i) { v0[i] = gelu_tanh(v0[i]); v1[i] = gelu_tanh(v1[i]); }
                        *(u32x4*)(YG + ((size_t)(ch * 16 + tau) * 512 + u.pb * 32 + j0)) = pack8(v0, v1); } } }
    }
};
struct EpiGlu {
    static constexpr bool PERM = true, AFTER_DRAIN = false, HOOK = false;
    const bf16_t* YG; const float* b_glu; bf16_t* YCAT;
    __device__ __forceinline__ void hook(f32x4 (&)[2][2][4][2], const Unit&, int, const Ctx&) const {}
    __device__ __forceinline__ void operator()(f32x4 (&acc)[2][2][4][2], const Unit& u, const Ctx& c) const {
#pragma unroll
        for (int bj = 0; bj < 2; ++bj) { const int c0 = COL8(u, c, bj);
            const f32x4 b0 = *(const f32x4*)(b_glu + c0), b1 = *(const f32x4*)(b_glu + c0 + 4);
#pragma unroll
            for (int ai = 0; ai < 2; ++ai)
#pragma unroll
                for (int m = 0; m < 4; ++m) { const int r = ROWOF(u, c, ai, m);
                    const u32x4 yw = *(const u32x4*)(YG + (size_t)r * 512 + c0); f32x4 y0, y1; unpack8(yw, y0, y1);
                    f32x4 v0 = acc[ai][bj][m][0] + b0, v1 = acc[ai][bj][m][1] + b1;
#pragma unroll
                    for (int i = 0; i < 4; ++i) { v0[i] = y0[i] * sigmoidf_(v0[i]); v1[i] = y1[i] * sigmoidf_(v1[i]); }
                    *(u32x4*)(YCAT + (size_t)r * 1024 + c0) = pack8(v0, v1); } }
    }
};
struct EpiMerge {
    static constexpr bool PERM = true, AFTER_DRAIN = false, HOOK = true;
    const bf16_t* GT; bf16_t* MG;
    __device__ __forceinline__ void hook(f32x4 (&acc)[2][2][4][2], const Unit& u, int t, const Ctx& c) const {
        if (t != 8 && t != 12) return;
        const int sel = (t == 8) ? 0 : 1;
#pragma unroll
        for (int ai = 0; ai < 2; ++ai) {
            u32x4 wa[4][2], wb[4][2];
#pragma unroll
            for (int m = 0; m < 4; ++m) { const int r = ROWOF(u, c, ai, m);
#pragma unroll
                for (int bj = 0; bj < 2; ++bj) { const bf16_t* gp = GT + (size_t)r * 3072 + sel * 1024 + COL8(u, c, bj); wa[m][bj] = *(const u32x4*)gp; wb[m][bj] = *(const u32x4*)(gp + 1024); } }
#pragma unroll
            for (int m = 0; m < 4; ++m)
#pragma unroll
                for (int bj = 0; bj < 2; ++bj) { f32x4 a0, a1, b0, b1; unpack8(wa[m][bj], a0, a1); unpack8(wb[m][bj], b0, b1);
#pragma unroll
                    for (int i = 0; i < 4; ++i) { acc[ai][bj][m][0][i] *= a0[i] * __builtin_amdgcn_rcpf(b0[i]); acc[ai][bj][m][1][i] *= a1[i] * __builtin_amdgcn_rcpf(b1[i]); } }
            asm volatile("" ::: "memory");
        }
    }
    __device__ __forceinline__ void operator()(f32x4 (&acc)[2][2][4][2], const Unit& u, const Ctx& c) const {
#pragma unroll
        for (int ai = 0; ai < 2; ++ai)
#pragma unroll
            for (int m = 0; m < 4; ++m) { const int r = ROWOF(u, c, ai, m);
#pragma unroll
                for (int bj = 0; bj < 2; ++bj) { const int c0 = COL8(u, c, bj);
                    const u32x4 wg = *(const u32x4*)(GT + (size_t)r * 3072 + 2048 + c0); f32x4 g0, g1; unpack8(wg, g0, g1);
                    *(u32x4*)(MG + (size_t)r * 1024 + c0) = pack8(acc[ai][bj][m][0] * g0, acc[ai][bj][m][1] * g1); } }
    }
};
struct EpiMemKV {
    static constexpr bool PERM = false, AFTER_DRAIN = false, HOOK = false;
    float* outK; float* outV; bf16_t* Kb; bf16_t* VTb;
    __device__ __forceinline__ void hook(f32x4 (&)[2][2][4][2], const Unit&, int, const Ctx&) const {}
    __device__ __forceinline__ void operator()(f32x4 (&acc)[2][2][4][2], const Unit& u, const Ctx& c) const {
#pragma unroll
        for (int ai = 0; ai < 2; ++ai)
#pragma unroll
            for (int m = 0; m < 4; ++m) { const int r = ROWOF(u, c, ai, m), b = r >> 8, mm = r & 255;
#pragma unroll
                for (int bj = 0; bj < 2; ++bj)
#pragma unroll
                    for (int n = 0; n < 2; ++n) { const int cc = bj * HALF + c.wc * 32 + 16 * n + 4 * c.fq, h = cc >> 6, d = cc & 63; const f32x4 v = acc[ai][bj][m][n];
                        if (u.pn == 0) { *(f32x4*)(outK + (size_t)r * 256 + cc) = v; u32x2 w; w.x = cvt_pk_bf16(v[0], v[1]); w.y = cvt_pk_bf16(v[2], v[3]); *(u32x2*)(Kb + ((size_t)((b * 4 + h) * 256 + mm) * 64 + d)) = w; }
                        else { *(f32x4*)(outV + (size_t)r * 256 + cc) = v;
#pragma unroll
                            for (int i = 0; i < 4; ++i) VTb[(size_t)((b * 4 + h) * 64 + d + i) * 256 + mm] = (bf16_t)(cvt_pk_bf16(v[i], 0.f) & 0xffffu); } } }
    }
};
struct EpiHalo {
    static constexpr bool PERM = true, AFTER_DRAIN = false, HOOK = false;
    float* HALO;
    __device__ __forceinline__ void hook(f32x4 (&)[2][2][4][2], const Unit&, int, const Ctx&) const {}
    __device__ __forceinline__ void operator()(f32x4 (&acc)[2][2][4][2], const Unit& u, const Ctx& c) const {
        const int ca = u.pn * 128 + c.wc * 32 + 8 * c.fq;
#pragma unroll
        for (int m = 0; m < 4; ++m) { const int hr = c.wr * 64 + m * 16 + c.fr;
            *(f32x4*)(HALO + (size_t)hr * DFF + ca) = acc[0][0][m][0]; *(f32x4*)(HALO + (size_t)hr * DFF + ca + 4) = acc[0][0][m][1]; }
    }
};
struct EpiUp {
    static constexpr bool PERM = true, AFTER_DRAIN = false, HOOK = false;
    bf16_t* ACT; const float* w_dw; const float* b_dw; const float* HALO; const float* state_conv; float* conv_p; float* conv_s;
    __device__ __forceinline__ void hook(f32x4 (&)[2][2][4][2], const Unit&, int, const Ctx&) const {}
    __device__ __forceinline__ void operator()(f32x4 (&acc)[2][2][4][2], const Unit& u, const Ctx& c) const {
        int cl = c.wc * 32 + 8 * c.fq, fr = c.fr; const int wr = c.wr;
        asm volatile("" : "+v"(cl), "+v"(fr));
        const int ca = u.pn * 128 + cl;
        const bool samp = (u.pm == 64);
        if (!samp) { if ((u.pm & 31) == 31 && wr == 1 && fr >= 14) { float* o = conv_p + (size_t)((u.pm >> 5) * 2 + fr - 14) * DFF + ca; *(f32x4*)o = acc[1][0][3][0]; *(f32x4*)(o + 4) = acc[1][0][3][1]; } }
        else if (fr >= 14) {
#pragma unroll
            for (int ai = 0; ai < 2; ++ai)
#pragma unroll
                for (int m = 0; m < 4; ++m) { float* o = conv_s + (size_t)((8 * ai + 4 * wr + m) * 2 + fr - 14) * DFF + ca; *(f32x4*)o = acc[ai][0][m][0]; *(f32x4*)(o + 4) = acc[ai][0][m][1]; } }
        PG8_LAS float* X = (PG8_LAS float*)c.xl;
        if (fr >= 14) {
#pragma unroll
            for (int ai = 0; ai < 2; ++ai) { PG8_LAS float* xp = X + ((ai * 2 + wr) * 2 + (fr - 14)) * 128 + cl; *(PG8_LAS f32x4*)xp = acc[ai][0][3][0]; *(PG8_LAS f32x4*)(xp + 4) = acc[ai][0][3][1]; } }
        asm volatile("s_waitcnt lgkmcnt(0)" ::: "memory"); __builtin_amdgcn_s_barrier(); asm volatile("" ::: "memory");
        const int k14 = (fr >= 14) ? fr - 14 : 0;
#pragma unroll
        for (int n = 0; n < 2; ++n) {
            const int can = ca + 4 * n, cln = cl + 4 * n;
            const f32x4 w0 = *(const f32x4*)(w_dw + can), w1 = *(const f32x4*)(w_dw + DFF + can), w2 = *(const f32x4*)(w_dw + 2 * DFF + can), bb = *(const f32x4*)(b_dw + can);
#pragma unroll
            for (int ai = 0; ai < 2; ++ai) {
                f32x4 bnd = (f32x4){0.f, 0.f, 0.f, 0.f};
                if (!samp) {
                    if (ai == 0 && wr == 0) { if ((u.pm & 31) != 0) bnd = *(const f32x4*)(HALO + (size_t)(2 * (u.pm - 1) + k14) * DFF + can); }
                    else { const int sai = (ai == 1 && wr == 1) ? 1 : 0, swr = (wr == 1) ? 0 : 1; bnd = *(const PG8_LAS f32x4*)(X + ((sai * 2 + swr) * 2 + k14) * 128 + cln); }
                }
#pragma unroll
                for (int m = 3; m >= 0; --m) {
                    const int r = u.pm * BM + ai * HALF + wr * 64 + m * 16 + fr;
                    f32x4 pv;
                    if (samp) pv = *(const f32x4*)(state_conv + (size_t)((8 * ai + 4 * wr + m) * 2 + k14) * DFF + can);
                    else if (m > 0) pv = acc[ai][0][m - 1][n];
                    else pv = bnd;
                    f32x4 o;
#pragma unroll
                    for (int i = 0; i < 4; ++i) {
                        const float cur = acc[ai][0][m][n][i];
                        const float q15 = __shfl(pv[i], 15, 16), q14 = __shfl(pv[i], 14, 16);
                        float p1 = __shfl_up(cur, 1, 16), p2 = __shfl_up(cur, 2, 16);
                        if (fr == 0) { p1 = q15; p2 = q14; } else if (fr == 1) { p2 = q15; }
                        const float cv = w0[i] * p2 + w1[i] * p1 + w2[i] * cur + bb[i];
                        o[i] = gelu_tanh(cv) * acc[ai][1][m][n][i];
                    }
                    u32x2 w; w.x = cvt_pk_bf16(o[0], o[1]); w.y = cvt_pk_bf16(o[2], o[3]);
                    *(u32x2*)(ACT + (size_t)r * DFF + can) = w;
                    __builtin_amdgcn_sched_barrier(0);
                }
            }
        }
    }
};

template <class Epi, class Sched, bool ALIGN_EPI = false, bool SP2 = true>
__device__ __forceinline__ void gemm_phase(PG8_LAS unsigned char* lds, PG8_LAS unsigned char* xl, const Gemm g, const Sched& S, const Epi& E) {
    const int tid = threadIdx.x, wid = __builtin_amdgcn_readfirstlane(tid >> 6), lane = tid & 63, wr = wid >> 2, wc = wid & 3, fr = lane & 15, fq = lane >> 4;
    Ctx ctx; ctx.wr = wr; ctx.wc = wc; ctx.fr = fr; ctx.fq = fq; ctx.wid = wid; ctx.lane = lane; ctx.xl = xl;
    const int K = g.K, nt = K / BK;
    unsigned voffA[2], voffB[2];
#pragma unroll
    for (int i = 0; i < 2; ++i) { int R, C; stage_rc(tid * 16 + i * 8192, R, C); const int Rb = Epi::PERM ? ((R & ~31) + perm32(R & 31)) : R;
        voffA[i] = (unsigned)(R * g.lda + C) * 2u; voffB[i] = (unsigned)(Rb * g.ldb + C) * 2u; }
    const size_t kstep = (size_t)(BK * 2);
    const size_t hstepA = (size_t)HALF * g.lda * 2, hstepB = (size_t)HALF * g.ldb * 2;
    const size_t tstepA = 2 * hstepA, tstepB = 2 * hstepB;
    const unsigned ldsw = (unsigned)wid * 1024u;
    const int aoff = lds_byte(wr * 64 + fr, fq * 8), boff = lds_byte(wc * 32 + fr, fq * 8);
#define PG8_SA(b, h) (((b) * 2 + (h)) * HTB)
#define PG8_SB(b, h) ((4 + (b) * 2 + (h)) * HTB)
#define PG8_STAGE(bufoff, gbase, voff) do { _Pragma("unroll") for (int _i = 0; _i < 2; ++_i) \
        __builtin_amdgcn_global_load_lds((const unsigned*)((const char*)(gbase) + (voff)[_i]), (PG8_LAS unsigned*)(lds + (bufoff) + ldsw + _i * 8192), 16, 0, 0); } while (0)
#define PG8_LDA(dst, b, h) do { _Pragma("unroll") for (int m = 0; m < 4; ++m) _Pragma("unroll") for (int k = 0; k < 2; ++k) dst[m][k] = *(const PG8_LAS bf16x8*)(lds + PG8_SA(b, h) + aoff + m * 2048 + k * 1024); } while (0)
#define PG8_LDB(dst, b, h) do { _Pragma("unroll") for (int n = 0; n < 2; ++n) _Pragma("unroll") for (int k = 0; k < 2; ++k) dst[n][k] = *(const PG8_LAS bf16x8*)(lds + PG8_SB(b, h) + boff + n * 2048 + k * 1024); } while (0)
#define PG8_MMA(ai, bj, At, Bt) do { __builtin_amdgcn_s_setprio(1); _Pragma("unroll") for (int m = 0; m < 4; ++m) _Pragma("unroll") for (int n = 0; n < 2; ++n) _Pragma("unroll") for (int k = 0; k < 2; ++k) \
        acc[ai][bj][m][n] = __builtin_amdgcn_mfma_f32_16x16x32_bf16(Bt[n][k], At[m][k], acc[ai][bj][m][n], 0, 0, 0); __builtin_amdgcn_s_setprio(0); } while (0)
#define PG8_WAIT_V(n) asm volatile("s_waitcnt vmcnt(" #n ")" ::: "memory")
#define PG8_WAIT_L(n) asm volatile("s_waitcnt lgkmcnt(" #n ")" ::: "memory")
#define PG8_BAR __builtin_amdgcn_s_barrier()
#define PG8_SCHED __builtin_amdgcn_sched_barrier(0)
    Unit cur, nxt; int ui = 0;
    if (!S.next(0, cur)) return;
    f32x4 acc[2][2][4][2];
#pragma unroll
    for (int a = 0; a < 2; ++a)
#pragma unroll
        for (int b = 0; b < 2; ++b)
#pragma unroll
            for (int m = 0; m < 4; ++m)
#pragma unroll
                for (int n = 0; n < 2; ++n) acc[a][b][m][n] = (f32x4){0.f, 0.f, 0.f, 0.f};
    bf16x8 At[4][2], B0[2][2], B1[2][2];
    const char* cA = (const char*)g.A + (size_t)cur.pb * g.bsA * 2 + (size_t)cur.pm * tstepA; const char* cB = (const char*)g.Bt + (size_t)cur.pb * g.bsB * 2 + (size_t)cur.pn * tstepB;
    if constexpr (SP2) {
        PG8_STAGE(PG8_SB(0, 0), cB, voffB); PG8_STAGE(PG8_SB(0, 1), cB + hstepB, voffB); PG8_STAGE(PG8_SA(0, 0), cA, voffA); PG8_STAGE(PG8_SA(0, 1), cA + hstepA, voffA);
        if (wr == 1) PG8_BAR;
        PG8_WAIT_V(2); PG8_BAR;
        PG8_STAGE(PG8_SB(1, 0), cB + kstep, voffB); PG8_STAGE(PG8_SA(1, 0), cA + kstep, voffA); PG8_STAGE(PG8_SB(1, 1), cB + hstepB + kstep, voffB);
        PG8_WAIT_V(6); PG8_BAR;
    } else {
        PG8_STAGE(PG8_SB(0, 0), cB, voffB); PG8_STAGE(PG8_SA(0, 0), cA, voffA); PG8_STAGE(PG8_SB(0, 1), cB + hstepB, voffB); PG8_STAGE(PG8_SA(0, 1), cA + hstepA, voffA);
        if (wr == 1) PG8_BAR;
        PG8_WAIT_V(4); PG8_BAR;
        PG8_STAGE(PG8_SB(1, 0), cB + kstep, voffB); PG8_STAGE(PG8_SA(1, 0), cA + kstep, voffA); PG8_STAGE(PG8_SB(1, 1), cB + hstepB + kstep, voffB);
        PG8_WAIT_V(6); PG8_BAR;
    }
    for (;;) {
        const bool has_next = S.next(ui + 1, nxt);
        const char* nA = has_next ? (const char*)g.A + (size_t)nxt.pb * g.bsA * 2 + (size_t)nxt.pm * tstepA : cA; const char* nB = has_next ? (const char*)g.Bt + (size_t)nxt.pb * g.bsB * 2 + (size_t)nxt.pn * tstepB : cB;
        for (int t = 0; t < nt; t += 2) {
            const bool last = (t == nt - 2);
            const char* a1 = cA + (size_t)(t + 1) * kstep;
            const char* a2 = last ? nA : cA + (size_t)(t + 2) * kstep; const char* b2 = last ? nB : cB + (size_t)(t + 2) * kstep;
            const char* a3 = a2 + kstep; const char* b3 = b2 + kstep;
            if constexpr (Epi::HOOK) { E.hook(acc, cur, t, ctx); PG8_SCHED; }
            if constexpr (SP2) {
            PG8_LDB(B0, 0, 0); PG8_LDB(B1, 0, 1); PG8_SCHED; PG8_LDA(At, 0, 0); PG8_STAGE(PG8_SA(1, 1), a1 + hstepA, voffA);
            PG8_WAIT_V(8); PG8_WAIT_L(0); PG8_BAR; PG8_MMA(0, 0, At, B0); PG8_MMA(0, 1, At, B1); PG8_BAR; PG8_SCHED;
            PG8_LDA(At, 0, 1); PG8_STAGE(PG8_SB(0, 0), b2, voffB); PG8_STAGE(PG8_SB(0, 1), b2 + hstepB, voffB); PG8_STAGE(PG8_SA(0, 0), a2, voffA);
            PG8_WAIT_V(8); PG8_WAIT_L(0); PG8_BAR; PG8_MMA(1, 0, At, B0); PG8_MMA(1, 1, At, B1); PG8_BAR; PG8_SCHED;
            PG8_LDB(B0, 1, 0); PG8_LDB(B1, 1, 1); PG8_SCHED; PG8_LDA(At, 1, 0); PG8_STAGE(PG8_SA(0, 1), a2 + hstepA, voffA);
            PG8_WAIT_V(8); PG8_WAIT_L(0); PG8_BAR; PG8_MMA(0, 0, At, B0); PG8_MMA(0, 1, At, B1); PG8_BAR; PG8_SCHED;
            PG8_LDA(At, 1, 1); PG8_STAGE(PG8_SB(1, 0), b3, voffB); PG8_STAGE(PG8_SB(1, 1), b3 + hstepB, voffB); PG8_STAGE(PG8_SA(1, 0), a3, voffA);
            PG8_WAIT_V(8); PG8_WAIT_L(0); PG8_BAR; PG8_MMA(1, 0, At, B0); PG8_MMA(1, 1, At, B1); PG8_BAR; PG8_SCHED;
            } else {
            PG8_LDB(B0, 0, 0); PG8_SCHED; PG8_LDA(At, 0, 0); PG8_STAGE(PG8_SA(1, 1), a1 + hstepA, voffA);
            PG8_WAIT_L(8); PG8_BAR; PG8_WAIT_L(0); PG8_MMA(0, 0, At, B0); PG8_BAR; PG8_SCHED;
            PG8_LDB(B1, 0, 1); PG8_STAGE(PG8_SB(0, 0), b2, voffB);
            PG8_BAR; PG8_WAIT_L(0); PG8_MMA(0, 1, At, B1); PG8_BAR;
            PG8_LDA(At, 0, 1); PG8_STAGE(PG8_SA(0, 0), a2, voffA);
            PG8_BAR; PG8_WAIT_L(0); PG8_MMA(1, 0, At, B0); PG8_BAR; PG8_SCHED;
            PG8_STAGE(PG8_SB(0, 1), b2 + hstepB, voffB);
            PG8_WAIT_V(6); PG8_BAR; PG8_MMA(1, 1, At, B1); PG8_BAR;
            PG8_LDB(B0, 1, 0); PG8_SCHED; PG8_LDA(At, 1, 0); PG8_STAGE(PG8_SA(0, 1), a2 + hstepA, voffA);
            PG8_WAIT_L(8); PG8_BAR; PG8_WAIT_L(0); PG8_MMA(0, 0, At, B0); PG8_BAR; PG8_SCHED;
            PG8_LDB(B1, 1, 1); PG8_STAGE(PG8_SB(1, 0), b3, voffB);
            PG8_BAR; PG8_WAIT_L(0); PG8_MMA(0, 1, At, B1); PG8_BAR;
            PG8_LDA(At, 1, 1); PG8_STAGE(PG8_SA(1, 0), a3, voffA);
            PG8_BAR; PG8_WAIT_L(0); PG8_MMA(1, 0, At, B0); PG8_BAR; PG8_SCHED;
            PG8_STAGE(PG8_SB(1, 1), b3 + hstepB, voffB);
            PG8_WAIT_V(6); PG8_BAR; PG8_MMA(1, 1, At, B1); PG8_BAR;
            }
        }
        if constexpr (ALIGN_EPI) { if (wr == 0) PG8_BAR; }
        E(acc, cur, ctx);
        if (!has_next) break;
#pragma unroll
        for (int a = 0; a < 2; ++a)
#pragma unroll
            for (int b = 0; b < 2; ++b)
#pragma unroll
                for (int m = 0; m < 4; ++m)
#pragma unroll
                    for (int n = 0; n < 2; ++n) acc[a][b][m][n] = (f32x4){0.f, 0.f, 0.f, 0.f};
        cur = nxt; cA = nA; cB = nB; ++ui;
        if constexpr (ALIGN_EPI) { if (wr == 1) PG8_BAR; }
    }
    PG8_WAIT_V(0);
    if constexpr (!ALIGN_EPI) { if (wr == 0) PG8_BAR; }
    PG8_BAR;
#undef PG8_SA
#undef PG8_SB
#undef PG8_STAGE
#undef PG8_LDA
#undef PG8_LDB
#undef PG8_MMA
#undef PG8_WAIT_V
#undef PG8_WAIT_L
#undef PG8_BAR
#undef PG8_SCHED
}
}

constexpr size_t MiB = 1u << 20;
constexpr size_t WS_CTL = 0, CTL_ZERO_BYTES = 64 * 1024;
constexpr size_t WS_WCAT1 = 1 * MiB;
constexpr size_t WS_WGLU = WS_WCAT1 + 8 * MiB;
constexpr size_t WS_WBR = WS_WGLU + MiB / 2;
constexpr size_t WS_WOUT = WS_WBR + 2 * MiB;
constexpr size_t WS_WUP = WS_WOUT + 2 * MiB;
constexpr size_t WS_WDOWN = WS_WUP + 11 * MiB;
constexpr size_t WS_WMEM = WS_WDOWN + 11 * MiB / 2;
constexpr size_t WS_YB = WS_WMEM + 1 * MiB;
constexpr size_t WS_SB = WS_YB + 12 * MiB;
constexpr size_t WS_HALO = WS_SB + 4 * MiB;
constexpr size_t WS_KB = WS_HALO + 11 * MiB / 4;
constexpr size_t WS_VTB = WS_KB + MiB / 4;
constexpr size_t WS_KS = WS_VTB + MiB / 4;
constexpr size_t WS_VTS = WS_KS + 2 * MiB;
constexpr size_t WS_MNB = WS_VTS + 2 * MiB;
constexpr size_t WS_PW16 = WS_MNB + 1 * MiB;
constexpr size_t WS_R1 = 56 * MiB;
constexpr size_t WS_R2 = WS_R1 + 98 * MiB;
constexpr size_t WS_R3 = WS_R2 + 33 * MiB;
constexpr size_t WS_R4 = WS_R3 + 65 * MiB / 2;
constexpr size_t WS_ZQ = WS_R4 + (size_t)NTOK * 256 * 2, WS_SC = WS_ZQ + (size_t)NTOK * 256 * 2;
constexpr size_t WS_END = 256 * MiB;
static_assert(WS_PW16 + 16384 <= WS_R1, "weights region");
static_assert((size_t)NTOK * 3072 * 2 <= 98 * MiB && (size_t)NTOK * DFF * 2 <= 98 * MiB && (size_t)H2ROWS * 1024 * 2 <= 33 * MiB && (size_t)16 * NCHP * 768 * 2 <= 65 * MiB / 2, "regions");
static_assert(WS_SC + (size_t)16 * NCHP * 256 * 4 <= WS_END && (size_t)NTOK * 1024 * 4 <= 33 * MiB + 65 * MiB / 2, "regions 2");
constexpr int CW_BAR = 1024;

constexpr int RING_BYTES = 131072, LDSCTL_OFF = RING_BYTES, MISC_OFF = LDSCTL_OFF + 320, XL_OFF = LDSCTL_OFF + 1024, LDS_BYTES = 147456;

#define GAS __attribute__((address_space(1)))
#define LAS __attribute__((address_space(3)))
typedef unsigned short bf16;
typedef unsigned v4u __attribute__((ext_vector_type(4)));
typedef float f32x4 __attribute__((ext_vector_type(4)));
typedef short bf16x8 __attribute__((ext_vector_type(8)));
#define RLX_AGENT __ATOMIC_RELAXED, __HIP_MEMORY_SCOPE_AGENT
#define LDS_WAIT() asm volatile("s_waitcnt lgkmcnt(0)" ::: "memory")
__device__ __forceinline__ unsigned f2bf(float f) { unsigned u = __builtin_bit_cast(unsigned, f); return (u + 0x7fffu + ((u >> 16) & 1u)) >> 16; }
__device__ __forceinline__ unsigned pk2(float lo, float hi) { return f2bf(lo) | (f2bf(hi) << 16); }
__device__ __forceinline__ float bf2f(bf16 v) { return __uint_as_float(((unsigned)v) << 16); }

#define XB_TMO      128
#define XB_XCNT(j)  (256  + 64 * (j))
#define XB_XSUB(j)  (1280 + 64 * (j))
#define XB_XGEN(j)  (2304 + 64 * (j))
#define XB_TOP      3328
#define XB_TOPGEN   3392
#define XCD_BAR_WORDS 3456
#define XB_SPIN_CAP (1u << 18)
__device__ __forceinline__ unsigned xb_ld(unsigned* p)              { return __hip_atomic_load(p, __ATOMIC_RELAXED, __HIP_MEMORY_SCOPE_AGENT); }
__device__ __forceinline__ unsigned xb_add(unsigned* p, unsigned v) { return __hip_atomic_fetch_add(p, v, __ATOMIC_RELAXED, __HIP_MEMORY_SCOPE_AGENT); }
__device__ __forceinline__ unsigned xb_xcc_id() { return (unsigned)__builtin_amdgcn_s_getreg((3 << 11) | 20) & 0xFu; }
#define XB_SPIN(cond, bar) do { unsigned _sp = 0; while (cond) { __builtin_amdgcn_s_sleep(1); \
    if ((++_sp & 255u) == 0u) { if (xb_ld(&(bar)[XB_TMO])) break; if (_sp > XB_SPIN_CAP) { atomicAdd(&(bar)[XB_TMO], 1u); break; } } } } while (0)
struct XcdBarrier { unsigned* bar; unsigned x; volatile LAS unsigned* st; };
__device__ __forceinline__ XcdBarrier xcd_barrier_post(unsigned* bar, volatile LAS unsigned* st) {
    XcdBarrier b; b.bar = bar; b.x = xb_xcc_id(); b.st = st;
    if (threadIdx.x == 0) (void)xb_add(&bar[XB_XCNT(b.x)], 1u);
    return b;
}
__device__ __forceinline__ void xcd_barrier_complete(unsigned* bar, unsigned x, unsigned& nloc, unsigned& nx) {
    const unsigned G = gridDim.x * gridDim.y * gridDim.z;
    unsigned sum, cnt, mine, sp = 0u;
    for (;;) {
        sum = 0u; cnt = 0u; mine = 0u;
#pragma unroll
        for (unsigned j = 0; j < 16; ++j) { const unsigned c = xb_ld(&bar[XB_XCNT(j)]); sum += c; cnt += (c > 0u) ? 1u : 0u; mine = (j == x) ? c : mine; }
        if (sum == G) break;
        __builtin_amdgcn_s_sleep(1);
        if ((++sp & 255u) == 0u) { if (xb_ld(&bar[XB_TMO])) break; if (sp > XB_SPIN_CAP) { atomicAdd(&bar[XB_TMO], 1u); break; } }
    }
    nloc = mine > 0u ? mine : 1u; nx = cnt > 0u ? cnt : 1u;
}
__device__ __forceinline__ void xcd_barrier(const XcdBarrier& b) {
    asm volatile("s_waitcnt vmcnt(0)" ::: "memory");
    __syncthreads();
    if (threadIdx.x == 0) {
        unsigned* bar = b.bar;
        __builtin_amdgcn_s_waitcnt(0);
        unsigned nloc = b.st[0], nx = b.st[1];
        if (nloc == 0u) { xcd_barrier_complete(bar, b.x, nloc, nx); b.st[0] = nloc; b.st[1] = nx; }
        const unsigned old = xb_add(&bar[XB_XSUB(b.x)], 1u);
        const unsigned gen = old / nloc;
        if (old + 1u == (gen + 1u) * nloc) {
            __builtin_amdgcn_fence(__ATOMIC_RELEASE, "agent");
            asm volatile("s_waitcnt vmcnt(0)" ::: "memory");
            const unsigned og = xb_add(&bar[XB_TOP], 1u);
            const unsigned tg = og / nx;
            if (og + 1u == (tg + 1u) * nx) xb_add(&bar[XB_TOPGEN], 1u);
            else XB_SPIN(xb_ld(&bar[XB_TOPGEN]) == tg, bar);
            __builtin_amdgcn_fence(__ATOMIC_ACQUIRE, "agent");
            xb_add(&bar[XB_XGEN(b.x)], 1u);
            asm volatile("s_waitcnt vmcnt(0)" ::: "memory");
        } else {
            XB_SPIN(xb_ld(&bar[XB_XGEN(b.x)]) == gen, bar);
            __builtin_amdgcn_fence(__ATOMIC_ACQUIRE, "agent");
            asm volatile("s_waitcnt vmcnt(0)" ::: "memory");
        }
    }
    __syncthreads();
}

struct Args { const float* in[39]; float* out; unsigned char* ws; int ph_lo, ph_hi; };
enum { I_XP = 0, I_XS, I_MEM, I_CK, I_CV, I_SRE, I_SIM, I_SPOOL, I_SCONV, I_GPRE1, I_WIN, I_LRE, I_LIM, I_LOGDT, I_BRE, I_BIM, I_CRE, I_CIM, I_SSMD, I_WGLU, I_BGLU, I_WPOOL, I_PSCALE,
       I_GMEM, I_WMK, I_WMV, I_WGATE, I_BGATE, I_WBRS, I_WBRP, I_WBRM, I_WOUT, I_GPOST1, I_GPRE2, I_WUP, I_WDW, I_BDW, I_WDOWN, I_GPOST2 };
constexpr size_t O_Y = 0, O_MK = (size_t)NTOK * 1024, O_MV = O_MK + 131072, O_SRP = O_MV + 131072, O_SIP = O_SRP + 4096, O_SRS = O_SIP + 4096, O_SIS = O_SRS + 32768,
                 O_PP = O_SIS + 32768, O_PS = O_PP + 7680, O_CP = O_PS + 61440, O_CS = O_CP + 11264, O_END = O_CS + 90112;

typedef __attribute__((address_space(4))) const unsigned char* kap_t;
typedef const float* cfp_t;
__device__ __forceinline__ kap_t launder(kap_t p) { asm volatile("" : "+s"(p)); return p; }
struct Frame {
    LAS unsigned char* lds; int tid, lane, wave, vcu, G;
    kap_t ka; float* out; unsigned char* ws;
};
#define INP(F, i) (*(const __attribute__((address_space(4))) cfp_t*)((F).ka + 8 * (i)))
__device__ __forceinline__ float wave_sum(float v) {
#pragma unroll
    for (int o = 1; o < 64; o <<= 1) v += __shfl_xor(v, o);
    return v;
}
__device__ __forceinline__ const float* xrow(const Frame& F, int r) { return r < MP ? INP(F, I_XP) + (size_t)r * D : INP(F, I_XS) + (size_t)(r - MP) * D; }

__device__ __forceinline__ void p0_transpose_item(const float* W, int K, int N, bf16* WT, int ldo, int koff, int row_off, int mode, LAS float* scr, int item, int lane) {
    const int nblk = N / 32, kb = item / nblk, nb = item % nblk, k0 = 64 * kb, n0 = 32 * nb;
#pragma unroll 8
    for (int i = 0; i < 32; ++i) { const int kk = 2 * i + (lane >> 5); scr[kk * 33 + (lane & 31)] = W[(size_t)(k0 + kk) * N + n0 + (lane & 31)]; }
    LDS_WAIT(); asm volatile("" ::: "memory");
    const int c = lane & 7;
    int ob;
    if (mode == 1) ob = (n0 < DFF) ? (n0 / 128) * 256 + (n0 % 128) : ((n0 - DFF) / 128) * 256 + 128 + ((n0 - DFF) % 128);
    else ob = row_off + n0;
#pragma unroll
    for (int j = 0; j < 4; ++j) { const int n = (lane >> 3) + 8 * j; const LAS float* s = scr + (8 * c) * 33 + n;
        v4u o; o.x = pk2(s[0 * 33], s[1 * 33]); o.y = pk2(s[2 * 33], s[3 * 33]); o.z = pk2(s[4 * 33], s[5 * 33]); o.w = pk2(s[6 * 33], s[7 * 33]);
        *(GAS v4u*)(WT + (size_t)(ob + n) * ldo + koff + k0 + 8 * c) = o; }
    LDS_WAIT(); asm volatile("" ::: "memory");
}
__device__ __forceinline__ void rms_row_to_bf16(const Frame& F, const float* xr_, const float* g, bf16* orow) {
    const f32x4* xr = (const f32x4*)xr_ + F.lane; const f32x4* gr = (const f32x4*)g + F.lane;
    f32x4 v[4]; float s = 0.f;
#pragma unroll
    for (int j = 0; j < 4; ++j) { v[j] = xr[64 * j]; s += (v[j].x * v[j].x + v[j].y * v[j].y) + (v[j].z * v[j].z + v[j].w * v[j].w); }
    const float rstd = 1.f / sqrtf(wave_sum(s) * (1.f / D) + EPS);
    unsigned long long* o8 = (unsigned long long*)orow + F.lane;
#pragma unroll
    for (int j = 0; j < 4; ++j) { const f32x4 gg = gr[64 * j]; o8[64 * j] = (unsigned long long)pk2(v[j].x * rstd * gg.x, v[j].y * rstd * gg.y) | ((unsigned long long)pk2(v[j].z * rstd * gg.z, v[j].w * rstd * gg.w) << 32); }
}

__device__ __forceinline__ void p0_ssm_tables(const Frame& F, int g) {
    LAS float* L = (LAS float*)F.lds;
    LAS float* pwr = L;
    LAS float* pwi = L + 17 * 64;
    LAS float* bbr = L + 2 * 17 * 64;
    LAS float* bbi = bbr + 1024;
    LAS float* ccr = bbi + 1024;
    LAS float* cci = ccr + 1024;
    LAS float* kt = cci + 1024;
    const int tid = F.tid;
    const float dt = expf(INP(F, I_LOGDT)[g]);
    for (int e = tid; e < 17 * 64; e += 512) { const int d = e >> 6, n = e & 63; const float lr = INP(F, I_LRE)[g * 64 + n], li = INP(F, I_LIM)[g * 64 + n];
        const float mag = expf(lr * dt * (float)d), ang = li * dt * (float)d; pwr[e] = mag * cosf(ang); pwi[e] = mag * sinf(ang); }
    for (int e = tid; e < 1024; e += 512) { const int n = e >> 4;
        const float lr = INP(F, I_LRE)[g * 64 + n], li = INP(F, I_LIM)[g * 64 + n]; const float mag = expf(lr * dt), ar = mag * cosf(li * dt), ai = mag * sinf(li * dt);
        const float den = lr * lr + li * li, nr = ar - 1.0f, ni = ai; const float zr = (nr * lr + ni * li) / den, zi = (ni * lr - nr * li) / den;
        const float br = INP(F, I_BRE)[(size_t)g * 1024 + e], bi = INP(F, I_BIM)[(size_t)g * 1024 + e];
        bbr[e] = zr * br - zi * bi; bbi[e] = zr * bi + zi * br;
        ccr[e] = INP(F, I_CRE)[(size_t)g * 1024 + e]; cci[e] = INP(F, I_CIM)[(size_t)g * 1024 + e]; }
    __syncthreads();
    if (tid < 64) { float* p = (float*)(F.ws + WS_PW16) + (size_t)(g * 64 + tid) * 2; p[0] = pwr[16 * 64 + tid]; p[1] = pwi[16 * 64 + tid]; }
    for (int e = tid; e < 4096; e += 512) { const int d = e >> 8, ho = (e >> 4) & 15, hi = e & 15; float s = 0.f;
        for (int n = 0; n < 64; ++n) { const float cr = ccr[ho * 64 + n], ci = cci[ho * 64 + n], pr = pwr[d * 64 + n], pi = pwi[d * 64 + n], br = bbr[n * 16 + hi], bi = bbi[n * 16 + hi];
            const float tr = cr * pr - ci * pi, ti = cr * pi + ci * pr; s += tr * br - ti * bi; }
        kt[e] = s; }
    __syncthreads();
    const int sg = g >> 1, gl = g & 1;
    bf16* YB = (bf16*)(F.ws + WS_YB) + (size_t)sg * 512 * 768;
    for (int e = tid; e < 256 * 384; e += 512) {
        const int rr = e / 384, kp = (e % 384) * 2, tau = rr >> 4, ho = rr & 15; float v[2];
#pragma unroll
        for (int q = 0; q < 2; ++q) { const int k = kp + q; float x = 0.f;
            if (k < 512) { const int s = k >> 5, jp = k & 31; if ((jp >> 4) == gl && s <= tau) x = kt[((tau - s) * 16 + ho) * 16 + (jp & 15)]; }
            else { const int kk = k - 512, g2 = kk >> 7, part = (kk >> 6) & 1, n = kk & 63;
                if (g2 == gl) { const float cr = ccr[ho * 64 + n], ci = cci[ho * 64 + n], pr = pwr[(tau + 1) * 64 + n], pi = pwi[(tau + 1) * 64 + n]; x = part == 0 ? (cr * pr - ci * pi) : -(cr * pi + ci * pr); } }
            v[q] = x; }
        *(unsigned*)(YB + (size_t)(tau * 32 + gl * 16 + ho) * 768 + kp) = pk2(v[0], v[1]);
    }
    bf16* SB = (bf16*)(F.ws + WS_SB) + (size_t)sg * 256 * 512;
    for (int e = tid; e < 128 * 256; e += 512) {
        const int rr = e >> 8, kp = (e & 255) * 2, part = rr >> 6, n = rr & 63; float v[2];
#pragma unroll
        for (int q = 0; q < 2; ++q) { const int k = kp + q, s = k >> 5, jp = k & 31; float x = 0.f;
            if ((jp >> 4) == gl) { const float pr = pwr[(15 - s) * 64 + n], pi = pwi[(15 - s) * 64 + n], br = bbr[n * 16 + (jp & 15)], bi = bbi[n * 16 + (jp & 15)]; x = part == 0 ? (pr * br - pi * bi) : (pr * bi + pi * br); }
            v[q] = x; }
        *(unsigned*)(SB + (size_t)(gl * 128 + part * 64 + n) * 512 + kp) = pk2(v[0], v[1]);
    }
    __syncthreads();
}

__device__ __forceinline__ void p0_prologue(const Frame& F) {
    if (F.vcu < 32) p0_ssm_tables(F, F.vcu);
    LAS float* scr = (LAS float*)(F.lds + F.wave * 16384);
    const int gw = F.vcu * 8 + F.wave, NGW = F.G * 8;
    bf16* Wcat1 = (bf16*)(F.ws + WS_WCAT1); bf16* Wglu = (bf16*)(F.ws + WS_WGLU); bf16* Wbr = (bf16*)(F.ws + WS_WBR); bf16* Wout = (bf16*)(F.ws + WS_WOUT);
    bf16* Wup = (bf16*)(F.ws + WS_WUP); bf16* Wdown = (bf16*)(F.ws + WS_WDOWN); bf16* Wmem = (bf16*)(F.ws + WS_WMEM);
    constexpr int I0 = 16 * 32, I1 = 16 * 96, I2 = 8 * 16, I3 = 8 * 32, I4 = 4 * 32, I5 = 16 * 32, I6 = 16 * 176, I7 = 44 * 32, I8 = 16 * 8, I9 = 16 * 8;
    constexpr int NITEMS = I0 + I1 + I2 + I3 + I4 + I5 + I6 + I7 + I8 + I9;
    for (int it = gw; it < NITEMS; it += NGW) {
        int r = it;
        if (r < I0) { p0_transpose_item(INP(F, I_WIN), 1024, 1024, Wcat1, 1024, 0, 0, 0, scr, r, F.lane); continue; } r -= I0;
        if (r < I1) { p0_transpose_item(INP(F, I_WGATE), 1024, 3072, Wcat1, 1024, 0, 1024, 0, scr, r, F.lane); continue; } r -= I1;
        if (r < I2) { p0_transpose_item(INP(F, I_WGLU), 512, 512, Wglu, 512, 0, 0, 0, scr, r, F.lane); continue; } r -= I2;
        if (r < I3) { p0_transpose_item(INP(F, I_WBRS), 512, 1024, Wbr, 1024, 0, 0, 0, scr, r, F.lane); continue; } r -= I3;
        if (r < I4) { p0_transpose_item(INP(F, I_WBRM), 256, 1024, Wbr, 1024, 768, 0, 0, scr, r, F.lane); continue; } r -= I4;
        if (r < I5) { p0_transpose_item(INP(F, I_WOUT), 1024, 1024, Wout, 1024, 0, 0, 0, scr, r, F.lane); continue; } r -= I5;
        if (r < I6) { p0_transpose_item(INP(F, I_WUP), 1024, NUP, Wup, 1024, 0, 0, 1, scr, r, F.lane); continue; } r -= I6;
        if (r < I7) { p0_transpose_item(INP(F, I_WDOWN), DFF, 1024, Wdown, DFF, 0, 0, 0, scr, r, F.lane); continue; } r -= I7;
        if (r < I8) { p0_transpose_item(INP(F, I_WMK), 1024, 256, Wmem, 1024, 0, 0, 0, scr, r, F.lane); continue; } r -= I8;
        p0_transpose_item(INP(F, I_WMV), 1024, 256, Wmem, 1024, 0, 256, 0, scr, r, F.lane);
    }
    { const int gt = F.vcu * 512 + F.tid, NT = F.G * 512;
      for (int e = gt; e < 1024 * 256; e += NT) { const int n = e >> 8, cc = e & 255, g = cc >> 6, cl = cc & 63; float s = 0.f;
          const float* wp = INP(F, I_WPOOL) + (size_t)(g * 64 + cl) * 64; const float* sc = INP(F, I_PSCALE) + g * 64; const float* wb = INP(F, I_WBRP) + (size_t)(g * 64) * 1024 + n;
          for (int d = 0; d < 64; ++d) s += wp[d] * sc[d] * wb[(size_t)d * 1024];
          Wbr[(size_t)n * 1024 + 512 + cc] = (bf16)f2bf(s); }
      bf16* Ks = (bf16*)(F.ws + WS_KS); bf16* VTs = (bf16*)(F.ws + WS_VTS);
      for (int e = gt; e < 16 * 256 * 256; e += NT) { const int d = e & 63, h = (e >> 6) & 3, m = (e >> 8) & 255, b = e >> 16;
          Ks[(size_t)((b * 4 + h) * 256 + m) * 64 + d] = (bf16)f2bf(INP(F, I_CK)[e]); }
      for (int e = gt; e < 16 * 256 * 256; e += NT) { const int m = e & 255, d = (e >> 8) & 63, h = (e >> 14) & 3, b = e >> 16;
          VTs[e] = (bf16)f2bf(INP(F, I_CV)[(size_t)((b * 256 + m) * 4 + h) * 64 + d]); }
    }
    bf16* HB = (bf16*)(F.ws + WS_R2); bf16* MNB = (bf16*)(F.ws + WS_MNB);
    for (int m = gw; m < NTOK + 512; m += NGW) {
        if (m < NTOK) rms_row_to_bf16(F, xrow(F, m), INP(F, I_GPRE1), HB + (size_t)m * D);
        else rms_row_to_bf16(F, INP(F, I_MEM) + (size_t)(m - NTOK) * D, INP(F, I_GMEM), MNB + (size_t)(m - NTOK) * D);
    }
}

__device__ __forceinline__ void attn_phase(const Frame& F) {
    typedef pg8::f32x4 f4;
    const bf16* ZQ = (const bf16*)(F.ws + WS_ZQ); bf16* YCAT = (bf16*)(F.ws + WS_R2);
    LAS unsigned char* VTl = F.lds; LAS unsigned char* Kl = F.lds + 33792; LAS unsigned char* Pl = F.lds + 33792 + F.wave * 8448;
    const int lane = F.lane, lr = lane & 15, lq = lane >> 4;
    for (int task = F.vcu; task < 576; task += F.G) {
        int tok0, ntok; const bf16* Kp; const bf16* VTp; const int h = task & 3;
        if (task < 512) { const int tile = task >> 2, b = tile >> 6; tok0 = tile * 128; ntok = 128; Kp = (const bf16*)(F.ws + WS_KB) + (size_t)(b * 4 + h) * 16384; VTp = (const bf16*)(F.ws + WS_VTB) + (size_t)(b * 4 + h) * 16384; }
        else { const int bs = (task - 512) >> 2; tok0 = MP + bs * 16; ntok = 16; Kp = (const bf16*)(F.ws + WS_KS) + (size_t)(bs * 4 + h) * 16384; VTp = (const bf16*)(F.ws + WS_VTS) + (size_t)(bs * 4 + h) * 16384; }
#pragma unroll
        for (int i = 0; i < 4; ++i) { const int id = F.tid + 512 * i;
            { const int row = id >> 3, ch = id & 7; *(LAS v4u*)(Kl + row * 144 + ch * 16) = *(const v4u*)(Kp + row * 64 + ch * 8); }
            { const int row = id >> 5, ch = id & 31; *(LAS v4u*)(VTl + row * 528 + ch * 16) = *(const v4u*)(VTp + row * 256 + ch * 8); } }
        __syncthreads();
        const bool active = (F.wave * 16 < ntok);
        const int trow = tok0 + F.wave * 16;
        f4 s[16]; float rs[4];
        if (active) {
            bf16x8 qa[2];
#pragma unroll
            for (int kk = 0; kk < 2; ++kk) qa[kk] = *(const bf16x8*)(ZQ + (size_t)(trow + lr) * 256 + h * 64 + kk * 32 + 8 * lq);
#pragma unroll
            for (int nb = 0; nb < 16; ++nb) { f4 a = (f4){0.f, 0.f, 0.f, 0.f};
#pragma unroll
                for (int kk = 0; kk < 2; ++kk) { const bf16x8 kb = *(const LAS bf16x8*)(Kl + (nb * 16 + lr) * 144 + kk * 64 + lq * 16); a = __builtin_amdgcn_mfma_f32_16x16x32_bf16(qa[kk], kb, a, 0, 0, 0); }
                s[nb] = a; }
            const float cs = 0.125f * 1.4426950408889634f;
#pragma unroll
            for (int r = 0; r < 4; ++r) { float mx = s[0][r];
#pragma unroll
                for (int nb = 1; nb < 16; ++nb) mx = fmaxf(mx, s[nb][r]);
                mx = fmaxf(mx, __shfl_xor(mx, 1)); mx = fmaxf(mx, __shfl_xor(mx, 2)); mx = fmaxf(mx, __shfl_xor(mx, 4)); mx = fmaxf(mx, __shfl_xor(mx, 8));
                float sum = 0.f;
#pragma unroll
                for (int nb = 0; nb < 16; ++nb) { const float p = __builtin_amdgcn_exp2f((s[nb][r] - mx) * cs); s[nb][r] = p; sum += p; }
                sum += __shfl_xor(sum, 1); sum += __shfl_xor(sum, 2); sum += __shfl_xor(sum, 4); sum += __shfl_xor(sum, 8);
                rs[r] = 1.0f / sum; }
        }
        __syncthreads();
        if (active) {
#pragma unroll
            for (int nb = 0; nb < 16; ++nb)
#pragma unroll
                for (int r = 0; r < 4; ++r) *(LAS bf16*)(Pl + (4 * lq + r) * 528 + (nb * 16 + lr) * 2) = (bf16)f2bf(s[nb][r]);
            LDS_WAIT(); asm volatile("" ::: "memory");
#pragma unroll
            for (int nd = 0; nd < 4; ++nd) { f4 o = (f4){0.f, 0.f, 0.f, 0.f};
#pragma unroll
                for (int ks = 0; ks < 8; ++ks) { const bf16x8 pa = *(const LAS bf16x8*)(Pl + lr * 528 + ks * 64 + lq * 16); const bf16x8 vb = *(const LAS bf16x8*)(VTl + (nd * 16 + lr) * 528 + ks * 64 + lq * 16);
                    o = __builtin_amdgcn_mfma_f32_16x16x32_bf16(pa, vb, o, 0, 0, 0); }
#pragma unroll
                for (int r = 0; r < 4; ++r) YCAT[(size_t)(trow + 4 * lq + r) * 1024 + 768 + h * 64 + nd * 16 + lr] = (bf16)f2bf(o[r] * rs[r]); }
        }
        __syncthreads();
    }
}

__device__ __forceinline__ void pool_phase(const Frame& F) {
    const bf16* ZP = (const bf16*)(F.ws + WS_R4); bf16* YCAT = (bf16*)(F.ws + WS_R2);
    const int c = F.tid & 255, sub = F.tid >> 8, g = c >> 6, w = 2 << g;
    for (int task = F.vcu; task < NTOK / 32; task += F.G) {
        const int t0 = task * 32 + sub * 16; int seq0, pos0; const float* hist = nullptr; int bidx;
        if (t0 < MP) { bidx = t0 / SEQ; seq0 = bidx * SEQ; pos0 = 0; } else { bidx = (t0 - MP) >> 4; seq0 = t0; pos0 = 2048; hist = INP(F, I_SPOOL) + (size_t)bidx * 15 * 256; }
        auto get = [&](int t) -> float { if (t >= seq0) return bf2f(ZP[(size_t)t * 256 + c]); if (hist) return hist[(size_t)(15 + t - seq0) * 256 + c]; return 0.f; };
        float sum = 0.f;
        for (int j = 1; j < w; ++j) sum += get(t0 - j);
        for (int t = t0; t < t0 + 16; ++t) {
            const float ut = get(t); sum += ut;
            const int p = pos0 + (t - seq0) + 1; const float cnt = (float)(p < w ? p : w);
            YCAT[(size_t)t * 1024 + 512 + c] = (bf16)f2bf(sum / cnt - ut);
            sum -= get(t - w + 1);
            const int li = t - seq0;
            if (t0 < MP) { if (li >= SEQ - 15) F.out[O_PP + (size_t)(bidx * 15 + li - (SEQ - 15)) * 256 + c] = ut; }
            else if (li >= 1) F.out[O_PS + (size_t)(bidx * 15 + li - 1) * 256 + c] = ut;
        }
    }
}

__device__ __forceinline__ void carry_phase(const Frame& F) {
    const float* SC = (const float*)(F.ws + WS_SC); bf16* AS = (bf16*)(F.ws + WS_R3); const float* PW = (const float*)(F.ws + WS_PW16);
    LAS float* E = (LAS float*)F.lds;
    for (int task = F.vcu; task < 64; task += F.G) {
        const int b = task >> 5, g = task & 31, sg = g >> 1, gl = g & 1, n = F.tid & 63, seg = F.tid >> 6;
        const float ar = PW[(g * 64 + n) * 2], ai = PW[(g * 64 + n) * 2 + 1];
        const size_t row0 = (size_t)sg * NCHP + b * 512 + seg * 64;
        const float* sp = SC + row0 * 256 + gl * 128 + n;
        float hr = 0.f, hi = 0.f;
        for (int cidx = 0; cidx < 64; ++cidx) { const float sr = sp[(size_t)cidx * 256], si = sp[(size_t)cidx * 256 + 64]; const float nr = ar * hr - ai * hi + sr, ni = ar * hi + ai * hr + si; hr = nr; hi = ni; }
        E[(seg * 64 + n) * 2] = hr; E[(seg * 64 + n) * 2 + 1] = hi;
        __syncthreads();
        float Ar = ar, Ai = ai;
#pragma unroll
        for (int q = 0; q < 6; ++q) { const float tr = Ar * Ar - Ai * Ai, ti = 2.f * Ar * Ai; Ar = tr; Ai = ti; }
        hr = 0.f; hi = 0.f;
        for (int k = 0; k < seg; ++k) { const float er = E[(k * 64 + n) * 2], ei = E[(k * 64 + n) * 2 + 1]; const float nr = Ar * hr - Ai * hi + er, ni = Ar * hi + Ai * hr + ei; hr = nr; hi = ni; }
        bf16* ap = AS + row0 * 768 + 512 + gl * 128 + n;
        for (int cidx = 0; cidx < 64; ++cidx) { ap[(size_t)cidx * 768] = (bf16)f2bf(hr); ap[(size_t)cidx * 768 + 64] = (bf16)f2bf(hi);
            const float sr = sp[(size_t)cidx * 256], si = sp[(size_t)cidx * 256 + 64]; const float nr = ar * hr - ai * hi + sr, ni = ar * hi + ai * hr + si; hr = nr; hi = ni; }
        if (seg == 7) { F.out[O_SRP + (size_t)(b * 32 + g) * 64 + n] = hr; F.out[O_SIP + (size_t)(b * 32 + g) * 64 + n] = hi; }
        __syncthreads();
    }
    if (F.vcu >= 64) {
        const int gt = (F.vcu - 64) * 512 + F.tid, NT = (F.G - 64) * 512;
        for (int e = gt; e < 16 * 32 * 64; e += NT) { const int n = e & 63, g = (e >> 6) & 31, bs = e >> 11, sg = g >> 1, gl = g & 1;
            const float ar = PW[(g * 64 + n) * 2], ai = PW[(g * 64 + n) * 2 + 1]; const float h0r = INP(F, I_SRE)[e], h0i = INP(F, I_SIM)[e];
            const size_t row = (size_t)sg * NCHP + 1024 + bs;
            AS[row * 768 + 512 + gl * 128 + n] = (bf16)f2bf(h0r); AS[row * 768 + 512 + gl * 128 + 64 + n] = (bf16)f2bf(h0i);
            const float sr = SC[row * 256 + gl * 128 + n], si = SC[row * 256 + gl * 128 + 64 + n];
            F.out[O_SRS + e] = ar * h0r - ai * h0i + sr; F.out[O_SIS + e] = ar * h0i + ai * h0r + si; }
    }
}

__device__ __forceinline__ void rowpass1(const Frame& F) {
    const float* RAW = (const float*)(F.ws + WS_R1); bf16* H2 = (bf16*)(F.ws + WS_R2);
    const int gw = F.vcu * 8 + F.wave, NGW = F.G * 8;
    for (int r = gw; r < NTOK; r += NGW) {
        const f32x4* rr = (const f32x4*)(RAW + (size_t)r * D) + F.lane; const f32x4* xr = (const f32x4*)xrow(F, r) + F.lane;
        const f32x4* g1 = (const f32x4*)INP(F, I_GPOST1) + F.lane; const f32x4* g2 = (const f32x4*)INP(F, I_GPRE2) + F.lane;
        f32x4 v[4]; float s = 0.f;
#pragma unroll
        for (int j = 0; j < 4; ++j) { v[j] = rr[64 * j]; s += (v[j].x * v[j].x + v[j].y * v[j].y) + (v[j].z * v[j].z + v[j].w * v[j].w); }
        const float rstd = 1.f / sqrtf(wave_sum(s) * (1.f / D) + EPS); float s2 = 0.f;
        f32x4* o = (f32x4*)(F.out + O_Y + (size_t)r * D) + F.lane;
#pragma unroll
        for (int j = 0; j < 4; ++j) { v[j] = xr[64 * j] + v[j] * rstd * g1[64 * j]; o[64 * j] = v[j]; s2 += (v[j].x * v[j].x + v[j].y * v[j].y) + (v[j].z * v[j].z + v[j].w * v[j].w); }
        const float rstd2 = 1.f / sqrtf(wave_sum(s2) * (1.f / D) + EPS);
        unsigned long long* o8 = (unsigned long long*)(H2 + (size_t)r * D) + F.lane;
        unsigned long long* oh = (r < MP && (r & 255) >= 254) ? (unsigned long long*)(H2 + (size_t)(NTOK + 2 * (r >> 8) + (r & 255) - 254) * D) + F.lane : nullptr;
#pragma unroll
        for (int j = 0; j < 4; ++j) { const f32x4 gg = g2[64 * j]; const unsigned long long w = (unsigned long long)pk2(v[j].x * rstd2 * gg.x, v[j].y * rstd2 * gg.y) | ((unsigned long long)pk2(v[j].z * rstd2 * gg.z, v[j].w * rstd2 * gg.w) << 32);
            o8[64 * j] = w; if (oh) oh[64 * j] = w; }
    }
}
__device__ __forceinline__ void rowpass2(const Frame& F) {
    const float* RAW = (const float*)(F.ws + WS_R2);
    const int gw = F.vcu * 8 + F.wave, NGW = F.G * 8;
    for (int r = gw; r < NTOK; r += NGW) {
        const f32x4* rr = (const f32x4*)(RAW + (size_t)r * D) + F.lane; const f32x4* g1 = (const f32x4*)INP(F, I_GPOST2) + F.lane;
        f32x4* o = (f32x4*)(F.out + O_Y + (size_t)r * D) + F.lane;
        f32x4 v[4]; float s = 0.f;
#pragma unroll
        for (int j = 0; j < 4; ++j) { v[j] = rr[64 * j]; s += (v[j].x * v[j].x + v[j].y * v[j].y) + (v[j].z * v[j].z + v[j].w * v[j].w); }
        const float rstd = 1.f / sqrtf(wave_sum(s) * (1.f / D) + EPS);
#pragma unroll
        for (int j = 0; j < 4; ++j) o[64 * j] = o[64 * j] + v[j] * rstd * g1[64 * j];
    }
}

constexpr int N_PHASES = 13;
__global__ void __launch_bounds__(512, 2) fwd_kernel(Args args) {
    extern __shared__ __attribute__((aligned(16))) unsigned char lds[];
    Frame F;
    F.lds = (LAS unsigned char*)lds; F.tid = threadIdx.x; F.lane = F.tid & 63; F.wave = __builtin_amdgcn_readfirstlane(F.tid >> 6);
    F.G = gridDim.x; { const int bx = blockIdx.x; F.vcu = (F.G % 8 == 0) ? (bx % 8) * (F.G / 8) + bx / 8 : bx; }
    F.ka = (kap_t)__builtin_amdgcn_kernarg_segment_ptr(); F.out = args.out; F.ws = args.ws;
    unsigned char* ws = args.ws;
    volatile LAS unsigned* MISC = (volatile LAS unsigned*)(F.lds + MISC_OFF);
    for (int u = F.tid; u < (LDS_BYTES - LDSCTL_OFF) / 4; u += 512) ((LAS unsigned*)(F.lds + LDSCTL_OFF))[u] = 0u;
    __syncthreads();
    const int lo = args.ph_lo, hi = args.ph_hi;
    const bool multi = (hi - lo) > 1;
    XcdBarrier bar; bar.bar = (unsigned*)(ws + WS_CTL) + CW_BAR; bar.x = 0; bar.st = nullptr;
    if (multi) bar = xcd_barrier_post((unsigned*)(ws + WS_CTL) + CW_BAR, MISC + 8);
#ifndef PHMASK
#define PHMASK 0xffffffffu
#endif
#define IN(k) (((PHMASK >> (k)) & 1u) && lo <= (k) && (k) < hi && ((F.ka = launder(F.ka)), true))
#define SEAM(k) do { if (IN(k) && IN((k) + 1)) xcd_barrier(bar); } while (0)
    LAS unsigned char* ring = F.lds; LAS unsigned char* xl = F.lds + XL_OFF;
    const int cb = (int)blockIdx.x;
    using namespace pg8;
    bf16_t* Wcat1 = (bf16_t*)(ws + WS_WCAT1); bf16_t* GT = (bf16_t*)(ws + WS_R1); bf16_t* HB = (bf16_t*)(ws + WS_R2); bf16_t* YCAT = HB; bf16_t* H2 = HB;
    bf16_t* AS = (bf16_t*)(ws + WS_R3); bf16_t* MG = AS; bf16_t* ZP = (bf16_t*)(ws + WS_R4); bf16_t* ZQ = (bf16_t*)(ws + WS_ZQ); float* SC = (float*)(ws + WS_SC); bf16_t* YG = ZP;
    bf16_t* ACT = GT; float* RAW1 = (float*)(ws + WS_R1); float* RAW2 = (float*)(ws + WS_R2); float* HALO = (float*)(ws + WS_HALO);

    if (IN(0)) { p0_prologue(F); } SEAM(0);
    if (IN(1)) {
        { Gemm g{HB, Wcat1, 1024, 1024, 1024, 0, 0}; StaticOrder S; S.init(65, 16, F.G, cb); EpiP1 E{AS, ZP, ZQ, GT, INP(F, I_BGATE)};
          gemm_phase<EpiP1, StaticOrder, true>(ring, xl, g, S, E); }
        { Gemm g{(const bf16_t*)(ws + WS_MNB), (const bf16_t*)(ws + WS_WMEM), 1024, 1024, 1024, 0, 0}; SubsetOrder S{32, 4, 2, cb}; EpiMemKV E{F.out + O_MK, F.out + O_MV, (bf16_t*)(ws + WS_KB), (bf16_t*)(ws + WS_VTB)};
          gemm_phase<EpiMemKV, SubsetOrder, false>(ring, xl, g, S, E); }
    } SEAM(1);
    if (IN(2)) {
        { Gemm g{AS, (const bf16_t*)(ws + WS_SB), 768, 512, 512, (size_t)NCHP * 768, (size_t)256 * 512}; BatchOrder S{5, 1, 16, F.G, cb}; EpiF32 E{SC, 256, (size_t)NCHP * 256};
          gemm_phase<EpiF32, BatchOrder, false>(ring, xl, g, S, E); }
        attn_phase(F);
        pool_phase(F);
    } SEAM(2);
    if (IN(3)) { carry_phase(F); } SEAM(3);
    if (IN(4)) { Gemm g{AS, (const bf16_t*)(ws + WS_YB), 768, 768, 768, (size_t)NCHP * 768, (size_t)512 * 768}; BatchOrder S{5, 2, 16, F.G, cb}; EpiY E{AS, INP(F, I_SSMD), YG};
        gemm_phase<EpiY, BatchOrder, false>(ring, xl, g, S, E); } SEAM(4);
    if (IN(5)) { Gemm g{YG, (const bf16_t*)(ws + WS_WGLU), 512, 512, 512, 0, 0}; StaticOrder S; S.init(65, 2, F.G, cb); EpiGlu E{YG, INP(F, I_BGLU), YCAT};
        gemm_phase<EpiGlu, StaticOrder, false>(ring, xl, g, S, E); } SEAM(5);
    if (IN(6)) { Gemm g{YCAT, (const bf16_t*)(ws + WS_WBR), 1024, 1024, 1024, 0, 0}; StaticOrder S; S.init(65, 4, F.G, cb); EpiMerge E{GT, MG};
        gemm_phase<EpiMerge, StaticOrder, true>(ring, xl, g, S, E); } SEAM(6);
    if (IN(7)) { Gemm g{MG, (const bf16_t*)(ws + WS_WOUT), 1024, 1024, 1024, 0, 0}; StaticOrder S; S.init(65, 4, F.G, cb); EpiF32 E{RAW1, 1024, 0};
        gemm_phase<EpiF32, StaticOrder, true>(ring, xl, g, S, E); } SEAM(7);
    if (IN(8)) { rowpass1(F); } SEAM(8);
    if (IN(9)) { Gemm g{H2, (const bf16_t*)(ws + WS_WUP), 1024, 1024, 1024, 0, 0}; HaloOrder HS{cb}; EpiHalo E{HALO};
        gemm_phase<EpiHalo, HaloOrder, false>(ring, xl, g, HS, E); } SEAM(9);
    if (IN(10)) { Gemm g{H2, (const bf16_t*)(ws + WS_WUP), 1024, 1024, 1024, 0, 0}; UpOrder S; S.s.init(64, 22, F.G, cb); S.G = F.G; S.c = cb;
        EpiUp E{ACT, INP(F, I_WDW), INP(F, I_BDW), HALO, INP(F, I_SCONV), F.out + O_CP, F.out + O_CS};
        gemm_phase<EpiUp, UpOrder, true>(ring, xl, g, S, E); } SEAM(10);
    if (IN(11)) { Gemm g{ACT, (const bf16_t*)(ws + WS_WDOWN), DFF, DFF, DFF, 0, 0}; StaticOrder S; S.init(65, 4, F.G, cb); EpiF32 E{RAW2, 1024, 0};
        gemm_phase<EpiF32, StaticOrder, true>(ring, xl, g, S, E); } SEAM(11);
    if (IN(12)) { rowpass2(F); }
#undef IN
#undef SEAM
}

#ifndef MK_PER_PHASE
#define MK_PER_PHASE 0
#endif
extern "C" void kernel_launch(void* const* d_in, const int* in_sizes, int n_in, void* d_out, int out_size, void* d_ws, size_t ws_size, hipStream_t stream) {
    static int grid = 0;
    if (grid == 0) {
        if (n_in != 39 || (size_t)out_size != O_END || ws_size < WS_END) { fprintf(stderr, "kernel_launch: unexpected shapes (n_in %d, out %d, ws %zu)\n", n_in, out_size, ws_size); grid = -1; return; }
        int dev = 0, cus = 0;
        if (hipGetDevice(&dev) != hipSuccess || hipDeviceGetAttribute(&cus, hipDeviceAttributeMultiprocessorCount, dev) != hipSuccess) { grid = -1; return; }
        if (hipFuncSetAttribute((const void*)fwd_kernel, hipFuncAttributeMaxDynamicSharedMemorySize, LDS_BYTES) != hipSuccess) { fprintf(stderr, "kernel_launch: hipFuncSetAttribute failed\n"); grid = -1; return; }
        (void)hipGetLastError();
        grid = cus;
    }
    if (grid < 0) return;
    (void)hipMemsetAsync((char*)d_ws + WS_CTL, 0, CTL_ZERO_BYTES, stream);
    Args a{};
    for (int i = 0; i < 39; ++i) a.in[i] = (const float*)d_in[i];
    a.out = (float*)d_out; a.ws = (unsigned char*)d_ws;
#if MK_PER_PHASE
    for (int p = 0; p < N_PHASES; ++p) { a.ph_lo = p; a.ph_hi = p + 1; hipLaunchKernelGGL(fwd_kernel, dim3(grid), dim3(512), LDS_BYTES, stream, a); }
#else
    a.ph_lo = 0; a.ph_hi = N_PHASES;
    hipLaunchKernelGGL(fwd_kernel, dim3(grid), dim3(512), LDS_BYTES, stream, a);
#endif
}
```
